# Optimizing an MI355X kernel written in HIP

```python
import math
import jax, jax.numpy as jnp
from jax import lax
import numpy as np

D_MODEL = 2048
BATCH = 4
SEQ = 2048
DEPTH = 1
DEC_BATCH = 128
DEC_SEQ = 8
PAST_LEN = 16384
PAGE_SIZE = 128

SSM_EXPAND = 2
D_INNER = SSM_EXPAND * D_MODEL
SSM_HEAD_DIM = 64
SSM_HEADS = D_INNER // SSM_HEAD_DIM
SSM_GROUPS = 8
SSM_STATE = 128
SSM_CONV = 4
SSM_CHUNK = 128
XBC_DIM = D_INNER + 2 * SSM_GROUPS * SSM_STATE
SC_DIM = D_MODEL
SC_CONV = 3
D_FF = 5632
FFN_CONV = 3
PLE_DIM = 256
EPS = 1e-6
IN_SPLITS = (D_INNER, XBC_DIM, SSM_HEADS, SC_DIM, SC_DIM, SC_DIM, D_MODEL, D_MODEL)
IN_DIM = sum(IN_SPLITS)

kernel_name = "hybrid_ssd_shortconv_convffn_step"


def split_last(t, sizes):
    idx = np.cumsum(sizes)[:-1].tolist()
    return jnp.split(t, idx, axis=-1)


def rmsnorm(x, g):
    xf = x.astype(jnp.float32)
    y = xf * lax.rsqrt(jnp.mean(xf * xf, axis=-1, keepdims=True) + EPS)
    return (y * g.astype(jnp.float32)).astype(x.dtype)


def causal_dwconv(x, past, w, b=None):
    K = w.shape[0]
    L = x.shape[1]
    xp = jnp.concatenate([past.astype(x.dtype), x], axis=1)
    y = xp[:, 0:L] * w[0]
    for k in range(1, K):
        y = y + xp[:, k:k + L] * w[k]
    if b is not None:
        y = y + b
    return y, xp[:, L:]


def ssd_scan(x, dt, A, Bm, Cm, h0):
    b, L = x.shape[0], x.shape[1]
    G, R, P, N = SSM_GROUPS, SSM_HEADS // SSM_GROUPS, SSM_HEAD_DIM, SSM_STATE
    Q = min(SSM_CHUNK, L)
    nc = -(-L // Q)
    pad = nc * Q - L
    if pad:
        padt = lambda t: jnp.pad(t, [(0, 0), (0, pad)] + [(0, 0)] * (t.ndim - 2))
        x, dt, Bm, Cm = padt(x), padt(dt), padt(Bm), padt(Cm)
    x = x.reshape(b, nc, Q, G, R, P)
    dt = dt.reshape(b, nc, Q, G, R)
    Bm = Bm.reshape(b, nc, Q, G, N)
    Cm = Cm.reshape(b, nc, Q, G, N)
    Acum = jnp.cumsum(dt * A.reshape(G, R), axis=2)
    seg = Acum[:, :, :, None] - Acum[:, :, None]
    causal = jnp.tril(jnp.ones((Q, Q), dtype=bool))[:, :, None, None]
    Lmat = jnp.exp(jnp.where(causal, seg, -jnp.inf))
    CB = jnp.einsum('bclgn,bcsgn->bclsg', Cm, Bm)
    Wm = CB[..., None] * Lmat * dt[:, :, None]
    y_diag = jnp.einsum('bclsgr,bcsgrp->bclgrp', Wm, x)
    decay_end = jnp.exp(Acum[:, :, -1:] - Acum)
    chunk_states = jnp.einsum('bclgn,bclgr,bclgrp->bcgrpn', Bm, decay_end * dt, x)
    chunk_decay = jnp.exp(Acum[:, :, -1])

    def step(h, inp):
        s, d = inp
        return d[..., None, None] * h + s, h

    hT, h_prev = lax.scan(step, h0.reshape(b, G, R, P, N),
                          (jnp.moveaxis(chunk_states, 1, 0), jnp.moveaxis(chunk_decay, 1, 0)))
    h_prev = jnp.moveaxis(h_prev, 0, 1)
    y_off = jnp.einsum('bclgn,bcgrpn,bclgr->bclgrp', Cm, h_prev, jnp.exp(Acum))
    y = (y_diag + y_off).reshape(b, nc * Q, SSM_HEADS, P)[:, :L]
    return y, hT.reshape(b, SSM_HEADS, P, N)


def trunk_layer(x, pe, ssm0, xbc0, sc0, ffn0,
                norm_mix, w_in, ssm_conv_w, ssm_conv_b, ssm_dt_bias, ssm_a_log, ssm_d, ssm_norm,
                w_ssm_out, sc_conv_w, w_sc_out, w_o, norm_ffn, w_ffn_gate, w_ffn_up,
                ffn_conv_w, ffn_conv_b, w_ffn_down, norm_ple, w_ple, w_ple_gate):
    f32 = jnp.float32
    b, L, _ = x.shape
    n1 = rmsnorm(x, norm_mix)
    proj = n1 @ w_in
    z, xbc, dt_raw, sc_b, sc_c, sc_h, gate_a, gate_b = split_last(proj, IN_SPLITS)

    xbc_c, xbc_state = causal_dwconv(xbc, xbc0, ssm_conv_w, ssm_conv_b)
    xbc_c = jax.nn.silu(xbc_c)
    xs, Bm, Cm = split_last(xbc_c, (D_INNER, SSM_GROUPS * SSM_STATE, SSM_GROUPS * SSM_STATE))
    xs_h = xs.reshape(b, L, SSM_HEADS, SSM_HEAD_DIM).astype(f32)
    dt = jax.nn.softplus(dt_raw.astype(f32) + ssm_dt_bias.astype(f32))
    A = -jnp.exp(ssm_a_log.astype(f32))
    y, h_new = ssd_scan(xs_h, dt, A,
                        Bm.reshape(b, L, SSM_GROUPS, SSM_STATE).astype(f32),
                        Cm.reshape(b, L, SSM_GROUPS, SSM_STATE).astype(f32),
                        ssm0.astype(f32))
    y = y + ssm_d.astype(f32)[:, None] * xs_h
    y = y.reshape(b, L, D_INNER) * jax.nn.silu(z.astype(f32))
    yg = y.reshape(b, L, SSM_GROUPS, D_INNER // SSM_GROUPS)
    yg = yg * lax.rsqrt(jnp.mean(yg * yg, axis=-1, keepdims=True) + EPS)
    y = (yg.reshape(b, L, D_INNER) * ssm_norm.astype(f32)).astype(x.dtype)
    branch_a = y @ w_ssm_out

    sc_conv, sc_state = causal_dwconv(sc_c * sc_h, sc0, sc_conv_w)
    branch_b = (sc_b * sc_conv) @ w_sc_out

    mixed = jax.nn.sigmoid(gate_a) * branch_a + jax.nn.sigmoid(gate_b) * branch_b
    x = x + mixed @ w_o

    n2 = rmsnorm(x, norm_ffn)
    g_up = n2 @ w_ffn_gate
    g_conv, ffn_state = causal_dwconv(g_up, ffn0, ffn_conv_w, ffn_conv_b)
    x = x + (jax.nn.silu(g_conv) * (n2 @ w_ffn_up)) @ w_ffn_down

    n3 = rmsnorm(x, norm_ple)
    x = x + (pe.astype(x.dtype) @ w_ple) * jax.nn.sigmoid(n3 @ w_ple_gate)
    return x, h_new.astype(ssm0.dtype), xbc_state, sc_state, ffn_state


def setup_inputs(seed: int = 0) -> dict:
    key = jax.random.key(seed)
    ks = iter(jax.random.split(key, 48))
    f32 = jnp.float32

    def nrm(shape, scale=1.0):
        return jax.random.normal(next(ks), shape, f32) * scale

    def gain(shape):
        return 1.0 + nrm(shape, 0.05)

    log_dt = jax.random.uniform(next(ks), (DEPTH, SSM_HEADS), f32,
                                minval=math.log(1e-3), maxval=math.log(1e-1))
    dt0 = jnp.exp(log_dt)
    dt_bias = dt0 + jnp.log(-jnp.expm1(-dt0))
    a_log = jnp.log(jax.random.uniform(next(ks), (DEPTH, SSM_HEADS), f32, minval=1.0, maxval=16.0))
    return {
        'x_prompt': nrm((BATCH, SEQ, D_MODEL)),
        'x_sample': nrm((DEC_BATCH, DEC_SEQ, D_MODEL)),
        'state_ssm': nrm((DEPTH, DEC_BATCH, SSM_HEADS, SSM_HEAD_DIM, SSM_STATE), 0.1),
        'state_ssm_conv': nrm((DEPTH, DEC_BATCH, SSM_CONV - 1, XBC_DIM)),
        'state_short_conv': nrm((DEPTH, DEC_BATCH, SC_CONV - 1, SC_DIM)),
        'state_ffn_conv': nrm((DEPTH, DEC_BATCH, FFN_CONV - 1, D_FF)),
        'p_prompt': nrm((DEPTH, BATCH, SEQ, PLE_DIM)),
        'p_sample': nrm((DEPTH, DEC_BATCH, DEC_SEQ, PLE_DIM)),
        'norm_mix': gain((DEPTH, D_MODEL)),
        'w_in': nrm((DEPTH, D_MODEL, IN_DIM), D_MODEL ** -0.5),
        'ssm_conv_w': nrm((DEPTH, SSM_CONV, XBC_DIM), 0.5),
        'ssm_conv_b': nrm((DEPTH, XBC_DIM), 0.02),
        'ssm_dt_bias': dt_bias,
        'ssm_a_log': a_log,
        'ssm_d': gain((DEPTH, SSM_HEADS)),
        'ssm_norm': gain((DEPTH, D_INNER)),
        'w_ssm_out': nrm((DEPTH, D_INNER, D_MODEL), D_INNER ** -0.5),
        'sc_conv_w': nrm((DEPTH, SC_CONV, SC_DIM), SC_CONV ** -0.5),
        'w_sc_out': nrm((DEPTH, SC_DIM, D_MODEL), SC_DIM ** -0.5),
        'w_o': nrm((DEPTH, D_MODEL, D_MODEL), D_MODEL ** -0.5),
        'norm_ffn': gain((DEPTH, D_MODEL)),
        'w_ffn_gate': nrm((DEPTH, D_MODEL, D_FF), D_MODEL ** -0.5),
        'w_ffn_up': nrm((DEPTH, D_MODEL, D_FF), D_MODEL ** -0.5),
        'ffn_conv_w': nrm((DEPTH, FFN_CONV, D_FF), FFN_CONV ** -0.5),
        'ffn_conv_b': nrm((DEPTH, D_FF), 0.02),
        'w_ffn_down': nrm((DEPTH, D_FF, D_MODEL), D_FF ** -0.5),
        'norm_ple': gain((DEPTH, D_MODEL)),
        'w_ple': nrm((DEPTH, PLE_DIM, D_MODEL), PLE_DIM ** -0.5),
        'w_ple_gate': nrm((DEPTH, D_MODEL, D_MODEL), D_MODEL ** -0.5),
        'norm_final': gain((D_MODEL,)),
    }


def reference(x_prompt, x_sample, state_ssm, state_ssm_conv, state_short_conv, state_ffn_conv,
              p_prompt, p_sample, norm_mix, w_in, ssm_conv_w, ssm_conv_b, ssm_dt_bias, ssm_a_log,
              ssm_d, ssm_norm, w_ssm_out, sc_conv_w, w_sc_out, w_o, norm_ffn, w_ffn_gate, w_ffn_up,
              ffn_conv_w, ffn_conv_b, w_ffn_down, norm_ple, w_ple, w_ple_gate, norm_final):
    dt_p = x_prompt.dtype
    yp, ys = x_prompt, x_sample
    ssm_p, ssm_s, xbc_p, xbc_s, sc_p, sc_s, ffn_p, ffn_s = [], [], [], [], [], [], [], []
    for i in range(DEPTH):
        lw = (norm_mix[i], w_in[i], ssm_conv_w[i], ssm_conv_b[i], ssm_dt_bias[i], ssm_a_log[i],
              ssm_d[i], ssm_norm[i], w_ssm_out[i], sc_conv_w[i], w_sc_out[i], w_o[i], norm_ffn[i],
              w_ffn_gate[i], w_ffn_up[i], ffn_conv_w[i], ffn_conv_b[i], w_ffn_down[i], norm_ple[i],
              w_ple[i], w_ple_gate[i])
        yp, s0, s1, s2, s3 = trunk_layer(
            yp, p_prompt[i],
            jnp.zeros((BATCH, SSM_HEADS, SSM_HEAD_DIM, SSM_STATE), dt_p),
            jnp.zeros((BATCH, SSM_CONV - 1, XBC_DIM), dt_p),
            jnp.zeros((BATCH, SC_CONV - 1, SC_DIM), dt_p),
            jnp.zeros((BATCH, FFN_CONV - 1, D_FF), dt_p),
            *lw)
        ssm_p.append(s0); xbc_p.append(s1); sc_p.append(s2); ffn_p.append(s3)
        ys, t0, t1, t2, t3 = trunk_layer(
            ys, p_sample[i], state_ssm[i], state_ssm_conv[i], state_short_conv[i], state_ffn_conv[i],
            *lw)
        ssm_s.append(t0); xbc_s.append(t1); sc_s.append(t2); ffn_s.append(t3)
    y_prompt = rmsnorm(yp, norm_final)
    y_sample = rmsnorm(ys, norm_final)
    return (y_prompt, y_sample,
            jnp.stack(ssm_p), jnp.stack(ssm_s),
            jnp.stack(xbc_p), jnp.stack(xbc_s),
            jnp.stack(sc_p), jnp.stack(sc_s),
            jnp.stack(ffn_p), jnp.stack(ffn_s))
```

```cpp
#include <hip/hip_runtime.h>
#include <hip/hip_cooperative_groups.h>
#include <cstdio>
#include <cstdint>
namespace cg = cooperative_groups;

namespace pg8 {
#define PG8_LAS __attribute__((address_space(3)))
typedef unsigned short bf16_t;
typedef short bf16x8 __attribute__((ext_vector_type(8)));
typedef float f32x4 __attribute__((ext_vector_type(4)));
typedef unsigned u32x4 __attribute__((ext_vector_type(4)));
constexpr int BM = 256, BK = 64, HALF = 128, HTB = HALF * BK * 2  , STAGE_BYTES = 8 * HTB, NXCD = 8, WGM = 8;

__host__ __device__ __forceinline__ int lds_byte(int r, int c) { const int st = (r >> 4) * 2 + (c >> 5), rr = r & 15, cc = c & 31, ob = rr * 64 + cc * 2; return st * 1024 + (ob ^ (((ob >> 9) & 1) << 5)); }
__host__ __device__ __forceinline__ void stage_rc(int b, int& R, int& C) { const int st = b / 1024, sb = b % 1024, swz = sb ^ (((sb >> 9) & 1) << 5); R = (st >> 1) * 16 + swz / 64; C = (st & 1) * 32 + (swz % 64) / 2; }
__host__ __device__ __forceinline__ int perm32(int rho) { const int n = rho >> 4, i = rho & 15; return 8 * (i >> 2) + 4 * n + (i & 3); }

struct Unit { int pm, pn; };
struct Gemm { const bf16_t* A; const bf16_t* Bt; int M, N, K; };

struct StaticOrder {
    int nM, nN, nwg, G, c;
    __host__ __device__ void init(int M, int N, int G_, int c_) { nM = M / BM; nN = N / BM; nwg = nM * nN; G = G_; c = c_; }
    __host__ __device__ bool next(int i, Unit& u) const {
        const long L = (long)i * G + c; if (L >= nwg) return false;
        int wgid = (int)L; { const int q = nwg / NXCD, r = nwg % NXCD, xcd = wgid % NXCD, off = wgid / NXCD; wgid = (xcd < r ? xcd * (q + 1) : r * (q + 1) + (xcd - r) * q) + off; }
        const int nig = WGM * nN, gid = wgid / nig, fm = gid * WGM, gsz = (nM - fm) < WGM ? (nM - fm) : WGM;
        u.pm = fm + ((wgid % nig) % gsz); u.pn = (wgid % nig) / gsz; return true;
    }
    __device__ __forceinline__ void a_ready(const Unit&) const {}
    __device__ __forceinline__ void done(const Unit&) const {}
};
__device__ __forceinline__ unsigned cvt_pk_bf16(float lo, float hi) { unsigned r; asm volatile("v_cvt_pk_bf16_f32 %0, %1, %2" : "=v"(r) : "v"(lo), "v"(hi)); return r; }
template <class Epi, class Sched, bool ALIGN_EPI = false, bool SP2 = false>
__device__ __forceinline__ void gemm_phase(PG8_LAS unsigned char* lds, const Gemm g, const Sched& S, const Epi& E) {
    const int tid = threadIdx.x, wid = __builtin_amdgcn_readfirstlane(tid >> 6), lane = tid & 63, wr = wid >> 2, wc = wid & 3, fr = lane & 15, fq = lane >> 4;
    const int K = g.K, nt = K / BK;
    unsigned voffA[2], voffB[2];
#pragma unroll
    for (int i = 0; i < 2; ++i) { int R, C; stage_rc(tid * 16 + i * 8192, R, C); const int Rb = Epi::PERM ? ((R & ~31) + perm32(R & 31)) : R;
        voffA[i] = (unsigned)(R * K + C) * 2u; voffB[i] = (unsigned)(Rb * K + C) * 2u; }
    const size_t kstep = (size_t)(BK * 2);
    const size_t hstep = (size_t)HALF * K * 2;
    const size_t tstep = 2 * hstep;
    const unsigned ldsw = (unsigned)wid * 1024u;
    const int aoff = lds_byte(wr * 64 + fr, fq * 8), boff = lds_byte(wc * 32 + fr, fq * 8);
#define PG8_SA(b, h) (((b) * 2 + (h)) * HTB)
#define PG8_SB(b, h) ((4 + (b) * 2 + (h)) * HTB)
#define PG8_STAGE(bufoff, gbase, voff) do { _Pragma("unroll") for (int _i = 0; _i < 2; ++_i) \
        __builtin_amdgcn_global_load_lds((const unsigned*)((const char*)(gbase) + (voff)[_i]), (PG8_LAS unsigned*)(lds + (bufoff) + ldsw + _i * 8192), 16, 0, 0); } while (0)
#define PG8_LDA(dst, b, h) do { _Pragma("unroll") for (int m = 0; m < 4; ++m) _Pragma("unroll") for (int k = 0; k < 2; ++k) dst[m][k] = *(const PG8_LAS bf16x8*)(lds + PG8_SA(b, h) + aoff + m * 2048 + k * 1024); } while (0)
#define PG8_LDB(dst, b, h) do { _Pragma("unroll") for (int n = 0; n < 2; ++n) _Pragma("unroll") for (int k = 0; k < 2; ++k) dst[n][k] = *(const PG8_LAS bf16x8*)(lds + PG8_SB(b, h) + boff + n * 2048 + k * 1024); } while (0)
#define PG8_MMA(ai, bj, At, Bt) do { __builtin_amdgcn_s_setprio(1); _Pragma("unroll") for (int m = 0; m < 4; ++m) _Pragma("unroll") for (int n = 0; n < 2; ++n) _Pragma("unroll") for (int k = 0; k < 2; ++k) \
        acc[ai][bj][m][n] = __builtin_amdgcn_mfma_f32_16x16x32_bf16(Bt[n][k], At[m][k], acc[ai][bj][m][n], 0, 0, 0); __builtin_amdgcn_s_setprio(0); } while (0)
#define PG8_WAIT_V(n) asm volatile("s_waitcnt vmcnt(" #n ")" ::: "memory")
#define PG8_WAIT_L(n) asm volatile("s_waitcnt lgkmcnt(" #n ")" ::: "memory")
#define PG8_BAR __builtin_amdgcn_s_barrier()
#define PG8_SCHED __builtin_amdgcn_sched_barrier(0)
    Unit cur, nxt; int ui = 0;
    if (!S.next(0, cur)) return;
    f32x4 acc[2][2][4][2];
#pragma unroll
    for (int a = 0; a < 2; ++a)
#pragma unroll
        for (int b = 0; b < 2; ++b)
#pragma unroll
            for (int m = 0; m < 4; ++m)
#pragma unroll
                for (int n = 0; n < 2; ++n) acc[a][b][m][n] = (f32x4){0.f, 0.f, 0.f, 0.f};
    bf16x8 At[4][2], B0[2][2], B1[2][2];
    const char* cA = (const char*)g.A + (size_t)cur.pm * tstep; const char* cB = (const char*)g.Bt + (size_t)cur.pn * tstep;
    S.a_ready(cur);
    if constexpr (SP2) {
        PG8_STAGE(PG8_SB(0, 0), cB, voffB); PG8_STAGE(PG8_SB(0, 1), cB + hstep, voffB); PG8_STAGE(PG8_SA(0, 0), cA, voffA); PG8_STAGE(PG8_SA(0, 1), cA + hstep, voffA);
        if (wr == 1) PG8_BAR;
        PG8_WAIT_V(2); PG8_BAR;
        PG8_STAGE(PG8_SB(1, 0), cB + kstep, voffB); PG8_STAGE(PG8_SA(1, 0), cA + kstep, voffA); PG8_STAGE(PG8_SB(1, 1), cB + hstep + kstep, voffB);
        PG8_WAIT_V(6); PG8_BAR;
    } else {
        PG8_STAGE(PG8_SB(0, 0), cB, voffB); PG8_STAGE(PG8_SA(0, 0), cA, voffA); PG8_STAGE(PG8_SB(0, 1), cB + hstep, voffB); PG8_STAGE(PG8_SA(0, 1), cA + hstep, voffA);
        if (wr == 1) PG8_BAR;
        PG8_WAIT_V(4); PG8_BAR;
        PG8_STAGE(PG8_SB(1, 0), cB + kstep, voffB); PG8_STAGE(PG8_SA(1, 0), cA + kstep, voffA); PG8_STAGE(PG8_SB(1, 1), cB + hstep + kstep, voffB);
        PG8_WAIT_V(6); PG8_BAR;
    }
    for (;;) {
        const bool has_next = S.next(ui + 1, nxt);
        const char* nA = has_next ? (const char*)g.A + (size_t)nxt.pm * tstep : cA; const char* nB = has_next ? (const char*)g.Bt + (size_t)nxt.pn * tstep : cB;
        for (int t = 0; t < nt; t += 2) {
            const bool last = (t == nt - 2);
            const char* a1 = cA + (size_t)(t + 1) * kstep;
            const char* a2 = last ? nA : cA + (size_t)(t + 2) * kstep; const char* b2 = last ? nB : cB + (size_t)(t + 2) * kstep;
            const char* a3 = a2 + kstep; const char* b3 = b2 + kstep;
            if (last && has_next) S.a_ready(nxt);
            if constexpr (SP2) {
            PG8_LDB(B0, 0, 0); PG8_LDB(B1, 0, 1); PG8_SCHED; PG8_LDA(At, 0, 0); PG8_STAGE(PG8_SA(1, 1), a1 + hstep, voffA);
            PG8_WAIT_V(8); PG8_WAIT_L(0); PG8_BAR; PG8_MMA(0, 0, At, B0); PG8_MMA(0, 1, At, B1); PG8_BAR; PG8_SCHED;
            PG8_LDA(At, 0, 1); PG8_STAGE(PG8_SB(0, 0), b2, voffB); PG8_STAGE(PG8_SB(0, 1), b2 + hstep, voffB); PG8_STAGE(PG8_SA(0, 0), a2, voffA);
            PG8_WAIT_V(8); PG8_WAIT_L(0); PG8_BAR; PG8_MMA(1, 0, At, B0); PG8_MMA(1, 1, At, B1); PG8_BAR; PG8_SCHED;
            PG8_LDB(B0, 1, 0); PG8_LDB(B1, 1, 1); PG8_SCHED; PG8_LDA(At, 1, 0); PG8_STAGE(PG8_SA(0, 1), a2 + hstep, voffA);
            PG8_WAIT_V(8); PG8_WAIT_L(0); PG8_BAR; PG8_MMA(0, 0, At, B0); PG8_MMA(0, 1, At, B1); PG8_BAR; PG8_SCHED;
            PG8_LDA(At, 1, 1); PG8_STAGE(PG8_SB(1, 0), b3, voffB); PG8_STAGE(PG8_SB(1, 1), b3 + hstep, voffB); PG8_STAGE(PG8_SA(1, 0), a3, voffA);
            PG8_WAIT_V(8); PG8_WAIT_L(0); PG8_BAR; PG8_MMA(1, 0, At, B0); PG8_MMA(1, 1, At, B1); PG8_BAR; PG8_SCHED;
            } else {
            PG8_LDB(B0, 0, 0); PG8_SCHED; PG8_LDA(At, 0, 0); PG8_STAGE(PG8_SA(1, 1), a1 + hstep, voffA);
            PG8_WAIT_L(8); PG8_BAR; PG8_WAIT_L(0); PG8_MMA(0, 0, At, B0); PG8_BAR; PG8_SCHED;
            PG8_LDB(B1, 0, 1); PG8_STAGE(PG8_SB(0, 0), b2, voffB);
            PG8_BAR; PG8_WAIT_L(0); PG8_MMA(0, 1, At, B1); PG8_BAR;
            PG8_LDA(At, 0, 1); PG8_STAGE(PG8_SA(0, 0), a2, voffA);
            PG8_BAR; PG8_WAIT_L(0); PG8_MMA(1, 0, At, B0); PG8_BAR; PG8_SCHED;
            PG8_STAGE(PG8_SB(0, 1), b2 + hstep, voffB);
            PG8_WAIT_V(6); PG8_BAR; PG8_MMA(1, 1, At, B1); PG8_BAR;
            PG8_LDB(B0, 1, 0); PG8_SCHED; PG8_LDA(At, 1, 0); PG8_STAGE(PG8_SA(0, 1), a2 + hstep, voffA);
            PG8_WAIT_L(8); PG8_BAR; PG8_WAIT_L(0); PG8_MMA(0, 0, At, B0); PG8_BAR; PG8_SCHED;
            PG8_LDB(B1, 1, 1); PG8_STAGE(PG8_SB(1, 0), b3, voffB);
            PG8_BAR; PG8_WAIT_L(0); PG8_MMA(0, 1, At, B1); PG8_BAR;
            PG8_LDA(At, 1, 1); PG8_STAGE(PG8_SA(1, 0), a3, voffA);
            PG8_BAR; PG8_WAIT_L(0); PG8_MMA(1, 0, At, B0); PG8_BAR; PG8_SCHED;
            PG8_STAGE(PG8_SB(1, 1), b3 + hstep, voffB);
            PG8_WAIT_V(6); PG8_BAR; PG8_MMA(1, 1, At, B1); PG8_BAR;
            }
        }
        if constexpr (ALIGN_EPI) { if (wr == 0) PG8_BAR; }
        if constexpr (!Epi::AFTER_DRAIN) { E(acc, cur, wr, wc, fr, fq); S.done(cur); }
        if (!has_next) break;
#pragma unroll
        for (int a = 0; a < 2; ++a)
#pragma unroll
            for (int b = 0; b < 2; ++b)
#pragma unroll
                for (int m = 0; m < 4; ++m)
#pragma unroll
                    for (int n = 0; n < 2; ++n) acc[a][b][m][n] = (f32x4){0.f, 0.f, 0.f, 0.f};
        cur = nxt; cA = nA; cB = nB; ++ui;
        if constexpr (ALIGN_EPI) { if (wr == 1) PG8_BAR; }
    }
    PG8_WAIT_V(0);
    if constexpr (!ALIGN_EPI) { if (wr == 0) PG8_BAR; }
    PG8_BAR;
    if constexpr (Epi::AFTER_DRAIN) { E.fused(acc, cur, wr, wc, fr, fq, lds, wid, lane); S.done(cur); }
#undef PG8_SA
#undef PG8_SB
#undef PG8_STAGE
#undef PG8_LDA
#undef PG8_LDB
#undef PG8_MMA
#undef PG8_WAIT_V
#undef PG8_WAIT_L
#undef PG8_BAR
#undef PG8_SCHED
}
}

#define LAS __attribute__((address_space(3)))
typedef unsigned short bf16;
typedef unsigned u32;
typedef unsigned long long u64;
typedef unsigned u32x2 __attribute__((ext_vector_type(2)));
typedef unsigned u32x4 __attribute__((ext_vector_type(4)));
typedef float f32x4 __attribute__((ext_vector_type(4)));
typedef short bf16x8 __attribute__((ext_vector_type(8)));
using pg8::cvt_pk_bf16;

constexpr int DM = 2048, NROW = 9216, NPR = 8192;
constexpr int NPROJ = 20736, NSRC = 20544;
constexpr int C_Z = 0, C_XBC = 4096, C_DT = 10240, C_SCB = 10496, C_SCC = 12544, C_SCH = 14592, C_GA = 16640, C_GB = 18688;
constexpr float EPS = 1e-6f;
constexpr int NPH = 12;
#ifndef MK_MAXPH
#define MK_MAXPH NPH
#endif
#ifndef MK_ONE_LAUNCH
#define MK_ONE_LAUNCH 0
#endif

constexpr size_t MiB = 1u << 20;
constexpr size_t WS_WIN = 0, WS_WA = 82 * MiB, WS_WB = 98 * MiB, WS_WO = 106 * MiB, WS_WGU = 114 * MiB, WS_WDN = 158 * MiB, WS_WPLE = 180 * MiB, WS_WPG = 181 * MiB;
constexpr size_t WS_XB = 190 * MiB  , WS_PEB = 226 * MiB, WS_DT = 231 * MiB, WS_SSQ = 234 * MiB, WS_RS = 237 * MiB;
constexpr size_t WS_SCBC = 238 * MiB, WS_Y = 274 * MiB, WS_MIX = 346 * MiB  , WS_XBCC = 382 * MiB  ;
constexpr size_t WS_PROJ = 490 * MiB  , WS_H = WS_PROJ + 198 * MiB, WS_END = 856 * MiB;
constexpr size_t O_Y = 0, O_SSMP = 18874368, O_SSMS = 20971520, O_CVP = 88080384, O_CVS = 88154112, O_SCP = 90513408, O_SCS = 90529792, O_FFP = 91054080, O_FFS = 91099136, O_END = 92540928;

constexpr int LDS_BYTES = 155648;

struct Args { const float* in[30]; float* out; unsigned char* ws; int ph_lo, ph_hi; };

__device__ __forceinline__ float bflo(u32 w) { return __uint_as_float(w << 16); }
__device__ __forceinline__ float bfhi(u32 w) { return __uint_as_float(w & 0xffff0000u); }
__device__ __forceinline__ float bf1(u32 b) { return __uint_as_float(b << 16); }
__device__ __forceinline__ u32 f2bf(float f) { u32 u = __float_as_uint(f); return (u + 0x7fffu + ((u >> 16) & 1u)) >> 16; }
__device__ __forceinline__ u32 pk2(float lo, float hi) { return cvt_pk_bf16(lo, hi); }
__device__ __forceinline__ u32 bfx(const u32x4& v, int j) { const u32 wd = v[j >> 1]; return (j & 1) ? (wd >> 16) : (wd & 0xffffu); }
__device__ __forceinline__ void unpack8(const u32x4& v, float (&o)[8]) { o[0] = bflo(v.x); o[1] = bfhi(v.x); o[2] = bflo(v.y); o[3] = bfhi(v.y); o[4] = bflo(v.z); o[5] = bfhi(v.z); o[6] = bflo(v.w); o[7] = bfhi(v.w); }
__device__ __forceinline__ u32x4 pack8(const float (&o)[8]) { u32x4 w; w.x = pk2(o[0], o[1]); w.y = pk2(o[2], o[3]); w.z = pk2(o[4], o[5]); w.w = pk2(o[6], o[7]); return w; }
__device__ __forceinline__ void ld8f(const float* p, float (&o)[8]) { const f32x4 a = *(const f32x4*)p, b = *(const f32x4*)(p + 4); o[0] = a.x; o[1] = a.y; o[2] = a.z; o[3] = a.w; o[4] = b.x; o[5] = b.y; o[6] = b.z; o[7] = b.w; }
__device__ __forceinline__ void st8f(float* p, const float (&o)[8]) { *(f32x4*)p = (f32x4){o[0], o[1], o[2], o[3]}; *(f32x4*)(p + 4) = (f32x4){o[4], o[5], o[6], o[7]}; }
__device__ __forceinline__ float sigmoidf_(float v) { return __builtin_amdgcn_rcpf(1.f + __expf(-v)); }
__device__ __forceinline__ float siluf_(float v) { return v * __builtin_amdgcn_rcpf(1.f + __expf(-v)); }
__device__ __forceinline__ float softplusf_(float v) { return v > 20.f ? v : log1pf(expf(v)); }
__device__ __forceinline__ float wave_sum(float v) {
#pragma unroll
    for (int o = 1; o < 64; o <<= 1) v += __shfl_xor(v, o);
    return v;
}
#define LDS_WAIT() asm volatile("s_waitcnt lgkmcnt(0)" ::: "memory")
#define MFMA16(a_, b_, c_) __builtin_amdgcn_mfma_f32_16x16x32_bf16(a_, b_, c_, 0, 0, 0)

#define EPI_HEAD const int row0 = u.pm * 256 + wr * 64 + fr, col0 = u.pn * 256 + wc * 32 + 8 * fq;
#define EPI_ROWS _Pragma("unroll") for (int ai = 0; ai < 2; ++ai) _Pragma("unroll") for (int m = 0; m < 4; ++m)
#define EPI_COLS _Pragma("unroll") for (int bj = 0; bj < 2; ++bj)
typedef const f32x4 (&AccRef)[2][2][4][2];

struct EpiProj {
    static constexpr bool PERM = true, AFTER_DRAIN = false;
    bf16* proj; float* dt; const float* rstd;
    __device__ __forceinline__ void operator()(AccRef acc, const pg8::Unit& u, int wr, int wc, int fr, int fq) const {
        EPI_HEAD
        const bool isdt = (u.pn == 40), isg = (u.pn >= 65);
        EPI_ROWS { const int row = row0 + ai * 128 + m * 16; const float rs = rstd[row];
            EPI_COLS { const int col = col0 + bj * 128; f32x4 v0 = acc[ai][bj][m][0] * rs, v1 = acc[ai][bj][m][1] * rs;
                if (isdt) { if (col < C_DT + 64) { float* d = dt + (size_t)row * 64 + (col - C_DT); *(f32x4*)d = v0; *(f32x4*)(d + 4) = v1; } }
                else {
                    if (isg) {
#pragma unroll
                        for (int j = 0; j < 4; ++j) { v0[j] = sigmoidf_(v0[j]); v1[j] = sigmoidf_(v1[j]); } }
                    u32x4 wv; wv.x = pk2(v0[0], v0[1]); wv.y = pk2(v0[2], v0[3]); wv.z = pk2(v1[0], v1[1]); wv.w = pk2(v1[2], v1[3]);
                    *(u32x4*)(proj + (size_t)row * NPROJ + col) = wv; } } }
    }
};
struct EpiGateA {
    static constexpr bool PERM = true, AFTER_DRAIN = false;
    const bf16* proj; float* T;
    __device__ __forceinline__ void operator()(AccRef acc, const pg8::Unit& u, int wr, int wc, int fr, int fq) const {
        EPI_HEAD
        EPI_ROWS { const int row = row0 + ai * 128 + m * 16;
            EPI_COLS { const int col = col0 + bj * 128; const u32x4 gw = *(const u32x4*)(proj + (size_t)row * NPROJ + C_GA + col);
                const f32x4 g0 = {bflo(gw.x), bfhi(gw.x), bflo(gw.y), bfhi(gw.y)}, g1 = {bflo(gw.z), bfhi(gw.z), bflo(gw.w), bfhi(gw.w)};
                float* t = T + (size_t)row * DM + col; *(f32x4*)t = acc[ai][bj][m][0] * g0; *(f32x4*)(t + 4) = acc[ai][bj][m][1] * g1; }
            asm volatile("" ::: "memory"); }
    }
};
struct EpiGateB {
    static constexpr bool PERM = true, AFTER_DRAIN = false;
    const bf16* proj; const float* T; bf16* mixed;
    __device__ __forceinline__ void operator()(AccRef acc, const pg8::Unit& u, int wr, int wc, int fr, int fq) const {
        EPI_HEAD
        EPI_ROWS { const int row = row0 + ai * 128 + m * 16;
            EPI_COLS { const int col = col0 + bj * 128; const u32x4 gw = *(const u32x4*)(proj + (size_t)row * NPROJ + C_GB + col);
                const f32x4 g0 = {bflo(gw.x), bfhi(gw.x), bflo(gw.y), bfhi(gw.y)}, g1 = {bflo(gw.z), bfhi(gw.z), bflo(gw.w), bfhi(gw.w)};
                const float* t = T + (size_t)row * DM + col; const f32x4 v0 = *(const f32x4*)t + acc[ai][bj][m][0] * g0, v1 = *(const f32x4*)(t + 4) + acc[ai][bj][m][1] * g1;
                u32x4 wv; wv.x = pk2(v0[0], v0[1]); wv.y = pk2(v0[2], v0[3]); wv.z = pk2(v1[0], v1[1]); wv.w = pk2(v1[2], v1[3]);
                *(u32x4*)(mixed + (size_t)row * DM + col) = wv; }
            asm volatile("" ::: "memory"); }
    }
};
struct EpiRes {
    static constexpr bool PERM = true, AFTER_DRAIN = false;
    const float* resA; const float* resB; float* out; bf16* xb; float* ssq;
    __device__ __forceinline__ void operator()(AccRef acc, const pg8::Unit& u, int wr, int wc, int fr, int fq) const {
        EPI_HEAD
        const float* res = (u.pm < 32) ? resA : resB;
        EPI_ROWS { const int row = row0 + ai * 128 + m * 16; float s = 0.f;
            EPI_COLS { const int col = col0 + bj * 128; const float* rp = res + (size_t)row * DM + col;
                const f32x4 v0 = *(const f32x4*)rp + acc[ai][bj][m][0], v1 = *(const f32x4*)(rp + 4) + acc[ai][bj][m][1];
                float* o = out + (size_t)row * DM + col; *(f32x4*)o = v0; *(f32x4*)(o + 4) = v1;
                s += (v0[0] * v0[0] + v0[1] * v0[1]) + (v0[2] * v0[2] + v0[3] * v0[3]) + (v1[0] * v1[0] + v1[1] * v1[1]) + (v1[2] * v1[2] + v1[3] * v1[3]);
                u32x4 wv; wv.x = pk2(v0[0], v0[1]); wv.y = pk2(v0[2], v0[3]); wv.z = pk2(v1[0], v1[1]); wv.w = pk2(v1[2], v1[3]);
                *(u32x4*)(xb + (size_t)row * DM + col) = wv; }
            s += __shfl_xor(s, 16); s += __shfl_xor(s, 32);
            if (fq == 0) atomicAdd(ssq + row, s);
            asm volatile("" ::: "memory"); }
    }
};
struct EpiGU {
    static constexpr bool PERM = true, AFTER_DRAIN = false;
    const float* ssq; bf16* gup;
    __device__ __forceinline__ void operator()(AccRef acc, const pg8::Unit& u, int wr, int wc, int fr, int fq) const {
        EPI_HEAD
        EPI_ROWS { const int row = row0 + ai * 128 + m * 16; const float rs = rsqrtf(ssq[row] * (1.f / DM) + EPS);
            EPI_COLS { const int col = col0 + bj * 128; const f32x4 v0 = acc[ai][bj][m][0] * rs, v1 = acc[ai][bj][m][1] * rs;
                u32x4 wv; wv.x = pk2(v0[0], v0[1]); wv.y = pk2(v0[2], v0[3]); wv.z = pk2(v1[0], v1[1]); wv.w = pk2(v1[2], v1[3]);
                *(u32x4*)(gup + (size_t)row * 11264 + col) = wv; } }
    }
};
struct EpiF32 {
    static constexpr bool PERM = true, AFTER_DRAIN = false;
    float* T;
    __device__ __forceinline__ void operator()(AccRef acc, const pg8::Unit& u, int wr, int wc, int fr, int fq) const {
        EPI_HEAD
        EPI_ROWS { const int row = row0 + ai * 128 + m * 16;
            EPI_COLS { const int col = col0 + bj * 128; float* t = T + (size_t)row * DM + col; *(f32x4*)t = acc[ai][bj][m][0]; *(f32x4*)(t + 4) = acc[ai][bj][m][1]; } }
    }
};
struct EpiPle {
    static constexpr bool PERM = true, AFTER_DRAIN = false;
    const float* ssq; const float* T; float* out;
    __device__ __forceinline__ void operator()(AccRef acc, const pg8::Unit& u, int wr, int wc, int fr, int fq) const {
        EPI_HEAD
        EPI_ROWS { const int row = row0 + ai * 128 + m * 16; const float rs = rsqrtf(ssq[row] * (1.f / DM) + EPS);
            EPI_COLS { const int col = col0 + bj * 128; const float* t = T + (size_t)row * DM + col; float* o = out + (size_t)row * DM + col;
                f32x4 v0 = *(const f32x4*)o, v1 = *(const f32x4*)(o + 4); const f32x4 t0 = *(const f32x4*)t, t1 = *(const f32x4*)(t + 4);
#pragma unroll
                for (int j = 0; j < 4; ++j) { v0[j] += t0[j] * sigmoidf_(acc[ai][bj][m][0][j] * rs); v1[j] += t1[j] * sigmoidf_(acc[ai][bj][m][1][j] * rs); }
                *(f32x4*)o = v0; *(f32x4*)(o + 4) = v1; }
            asm volatile("" ::: "memory"); }
    }
};

__device__ __forceinline__ void tr_item(const float* __restrict__ W, int K, int N, bf16* WT, int row_off, int split_at, int split_extra, const float* gain, LAS float* scr, int item, int lane) {
    const int nblk = N >> 6, kb = item / nblk, nb = item - kb * nblk, k0 = kb << 6, n0 = nb << 6;
    const int c4 = (lane & 15) << 2, kr = lane >> 4;
#pragma unroll
    for (int i = 0; i < 16; ++i) { const int kk = kr + 4 * i; const f32x4 v = *(const f32x4*)(W + (size_t)(k0 + kk) * N + n0 + c4);
        LAS float* d = scr + kk * 65 + c4; d[0] = v.x; d[1] = v.y; d[2] = v.z; d[3] = v.w; }
    LDS_WAIT();
    const int c = lane & 7;
    float gk[8];
#pragma unroll
    for (int i = 0; i < 8; ++i) gk[i] = gain ? gain[k0 + 8 * c + i] : 1.f;
#pragma unroll
    for (int j = 0; j < 8; ++j) { const int n = (lane >> 3) + 8 * j; const LAS float* s = scr + (8 * c) * 65 + n;
        u32x4 o; o.x = pk2(s[0] * gk[0], s[65] * gk[1]); o.y = pk2(s[130] * gk[2], s[195] * gk[3]); o.z = pk2(s[260] * gk[4], s[325] * gk[5]); o.w = pk2(s[390] * gk[6], s[455] * gk[7]);
        int nd = n0 + n; nd += (nd >= split_at) ? split_extra : 0;
        *(u32x4*)(WT + (size_t)(row_off + nd) * K + k0 + 8 * c) = o; }
    LDS_WAIT();
}
__device__ __forceinline__ void ph_prologue(const Args& a, LAS unsigned char* lds, int G) {
    const int tid = threadIdx.x, lane = tid & 63, w = tid >> 6;
    const int gw = blockIdx.x * 8 + w, NGW = G * 8, gt = blockIdx.x * 512 + tid, NT = G * 512;
    unsigned char* ws = a.ws;
    LAS float* scr = (LAS float*)(lds + w * 16640);
    constexpr int I_IN = 32 * 321, I_A = 64 * 32, I_SQ = 32 * 32, I_GU = 32 * 88, I_DN = 88 * 32, I_PLE = 4 * 32;
    constexpr int NIT = I_IN + I_A + 3 * I_SQ + 2 * I_GU + I_DN + I_PLE;
    constexpr int NOSPLIT = 1 << 30;
    for (int it = gw; it < NIT; it += NGW) {
        int r = it;
        if (r < I_IN) { tr_item(a.in[9], 2048, NSRC, (bf16*)(ws + WS_WIN), 0, 10304, 192, a.in[8], scr, r, lane); continue; } r -= I_IN;
        if (r < I_A) { tr_item(a.in[16], 4096, 2048, (bf16*)(ws + WS_WA), 0, NOSPLIT, 0, a.in[15], scr, r, lane); continue; } r -= I_A;
        if (r < I_SQ) { tr_item(a.in[18], 2048, 2048, (bf16*)(ws + WS_WB), 0, NOSPLIT, 0, nullptr, scr, r, lane); continue; } r -= I_SQ;
        if (r < I_SQ) { tr_item(a.in[19], 2048, 2048, (bf16*)(ws + WS_WO), 0, NOSPLIT, 0, nullptr, scr, r, lane); continue; } r -= I_SQ;
        if (r < I_GU) { tr_item(a.in[21], 2048, 5632, (bf16*)(ws + WS_WGU), 0, NOSPLIT, 0, a.in[20], scr, r, lane); continue; } r -= I_GU;
        if (r < I_GU) { tr_item(a.in[22], 2048, 5632, (bf16*)(ws + WS_WGU), 5632, NOSPLIT, 0, a.in[20], scr, r, lane); continue; } r -= I_GU;
        if (r < I_DN) { tr_item(a.in[25], 5632, 2048, (bf16*)(ws + WS_WDN), 0, NOSPLIT, 0, nullptr, scr, r, lane); continue; } r -= I_DN;
        if (r < I_PLE) { tr_item(a.in[27], 256, 2048, (bf16*)(ws + WS_WPLE), 0, NOSPLIT, 0, nullptr, scr, r, lane); continue; } r -= I_PLE;
        tr_item(a.in[28], 2048, 2048, (bf16*)(ws + WS_WPG), 0, NOSPLIT, 0, a.in[26], scr, r, lane);
    }
    { u32x4* z = (u32x4*)((bf16*)(ws + WS_WIN) + (size_t)10304 * 2048); for (int i = gt; i < 192 * 2048 / 8; i += NT) z[i] = (u32x4){0u, 0u, 0u, 0u};
      float* s = (float*)(ws + WS_RS) + NROW; for (int i = gt; i < 2 * NROW; i += NT) s[i] = 0.f; }
    { bf16* xb = (bf16*)(ws + WS_XB); float* rstd = (float*)(ws + WS_RS);
      for (int m = gw; m < NROW; m += NGW) {
          const float* xrow = (m < NPR) ? a.in[0] + (size_t)m * DM : a.in[1] + (size_t)(m - NPR) * DM;
          const f32x4* xr = (const f32x4*)xrow + lane; f32x4 v[8]; float s = 0.f;
#pragma unroll
          for (int j = 0; j < 8; ++j) { v[j] = xr[64 * j]; s += (v[j].x * v[j].x + v[j].y * v[j].y) + (v[j].z * v[j].z + v[j].w * v[j].w); }
          s = wave_sum(s);
          if (lane == 0) rstd[m] = rsqrtf(s * (1.f / DM) + EPS);
          u32x2* o8 = (u32x2*)(xb + (size_t)m * DM) + lane;
#pragma unroll
          for (int j = 0; j < 8; ++j) o8[64 * j] = (u32x2){pk2(v[j].x, v[j].y), pk2(v[j].z, v[j].w)}; } }
    { bf16* peb = (bf16*)(ws + WS_PEB);
      for (int i = gt; i < NROW * 256 / 8; i += NT) { const size_t e = (size_t)i * 8; const float* src = (e < (size_t)NPR * 256) ? a.in[6] + e : a.in[7] + (e - (size_t)NPR * 256);
          float t[8]; ld8f(src, t); *(u32x4*)(peb + e) = pack8(t); } }
}

__device__ __forceinline__ void ph_conv(const Args& a, int G) {
    const int gt = blockIdx.x * 512 + threadIdx.x, NT = G * 512;
    const bf16* proj = (const bf16*)(a.ws + WS_PROJ); bf16* xbcc = (bf16*)(a.ws + WS_XBCC); bf16* scbc = (bf16*)(a.ws + WS_SCBC); float* out = a.out;
    for (int u = gt; u < 1152 * 768; u += NT) {
        const int tg = u / 768, c0 = (u - tg * 768) * 8, r0 = tg * 8; const bool prompt = tg < 1024; const int sb = tg - 1024, pb = tg >> 8;
        float wk[4][8], bs[8], win[3][8];
#pragma unroll
        for (int k = 0; k < 4; ++k) ld8f(a.in[10] + k * 6144 + c0, wk[k]);
        ld8f(a.in[11] + c0, bs);
#pragma unroll
        for (int k = 0; k < 3; ++k) {
            if (prompt) { if ((tg & 255) == 0) {
#pragma unroll
                    for (int e = 0; e < 8; ++e) win[k][e] = 0.f; }
                else unpack8(*(const u32x4*)(proj + (size_t)(r0 - 3 + k) * NPROJ + C_XBC + c0), win[k]); }
            else ld8f(a.in[3] + ((size_t)sb * 3 + k) * 6144 + c0, win[k]); }
        const bool last = prompt ? ((tg & 255) == 255) : true;
#pragma unroll
        for (int j = 0; j < 8; ++j) {
            float cur[8], o[8]; unpack8(*(const u32x4*)(proj + (size_t)(r0 + j) * NPROJ + C_XBC + c0), cur);
#pragma unroll
            for (int e = 0; e < 8; ++e) { const float y = bs[e] + wk[0][e] * win[0][e] + wk[1][e] * win[1][e] + wk[2][e] * win[2][e] + wk[3][e] * cur[e]; o[e] = siluf_(y); }
            *(u32x4*)(xbcc + (size_t)(r0 + j) * 6144 + c0) = pack8(o);
            if (j >= 5 && last) { float* d = prompt ? out + O_CVP + ((size_t)pb * 3 + (j - 5)) * 6144 + c0 : out + O_CVS + ((size_t)sb * 3 + (j - 5)) * 6144 + c0; st8f(d, cur); }
#pragma unroll
            for (int e = 0; e < 8; ++e) { win[0][e] = win[1][e]; win[1][e] = win[2][e]; win[2][e] = cur[e]; } }
    }
    for (int u = gt; u < 1152 * 256; u += NT) {
        const int tg = u >> 8, c0 = (u & 255) * 8, r0 = tg * 8; const bool prompt = tg < 1024; const int sb = tg - 1024, pb = tg >> 8;
        float wk[3][8], up[2][8];
#pragma unroll
        for (int k = 0; k < 3; ++k) ld8f(a.in[17] + k * 2048 + c0, wk[k]);
#pragma unroll
        for (int k = 0; k < 2; ++k) {
            if (prompt) { if ((tg & 255) == 0) {
#pragma unroll
                    for (int e = 0; e < 8; ++e) up[k][e] = 0.f; }
                else { float cc[8], hh[8]; const bf16* p = proj + (size_t)(r0 - 2 + k) * NPROJ + c0; unpack8(*(const u32x4*)(p + C_SCC), cc); unpack8(*(const u32x4*)(p + C_SCH), hh);
#pragma unroll
                    for (int e = 0; e < 8; ++e) up[k][e] = cc[e] * hh[e]; } }
            else ld8f(a.in[4] + ((size_t)sb * 2 + k) * 2048 + c0, up[k]); }
        const bool last = prompt ? ((tg & 255) == 255) : true;
#pragma unroll
        for (int j = 0; j < 8; ++j) {
            float cc[8], hh[8], bb[8], uc[8], o[8]; const bf16* p = proj + (size_t)(r0 + j) * NPROJ + c0;
            unpack8(*(const u32x4*)(p + C_SCC), cc); unpack8(*(const u32x4*)(p + C_SCH), hh); unpack8(*(const u32x4*)(p + C_SCB), bb);
#pragma unroll
            for (int e = 0; e < 8; ++e) { uc[e] = cc[e] * hh[e]; const float v = wk[0][e] * up[0][e] + wk[1][e] * up[1][e] + wk[2][e] * uc[e]; o[e] = bb[e] * v; }
            *(u32x4*)(scbc + (size_t)(r0 + j) * DM + c0) = pack8(o);
            if (j >= 6 && last) { float* d = prompt ? out + O_SCP + ((size_t)pb * 2 + (j - 6)) * 2048 + c0 : out + O_SCS + ((size_t)sb * 2 + (j - 6)) * 2048 + c0; st8f(d, uc); }
#pragma unroll
            for (int e = 0; e < 8; ++e) { up[0][e] = up[1][e]; up[1][e] = uc[e]; } }
    }
}

__device__ __forceinline__ int sw128(int r, int k) { return r * 256 + ((((k >> 3) ^ (r & 15)) << 4) | ((k & 7) << 1)); }
__device__ __forceinline__ bf16x8 ldfrag(LAS const unsigned char* base, int r, int ks, int q) { return *(LAS const bf16x8*)(base + r * 256 + ((((ks << 2) | q) ^ (r & 15)) << 4)); }

__device__ __forceinline__ bf16x8 ldfragp(LAS const unsigned char* base, int r, int ks, int q) { return *(LAS const bf16x8*)(base + r * 272 + ks * 64 + q * 16); }
__device__ __forceinline__ void ssd_prompt(const Args& a, LAS unsigned char* lds, int G) {
    constexpr int O_BS = 0, O_CS = 32768, O_HS = 65536, O_BT = 81920, O_XT = 116736, O_XW = 134144, O_SM = 151552;
    const int tid = threadIdx.x, lane = tid & 63, w = __builtin_amdgcn_readfirstlane(tid >> 6), fr = lane & 15, q = lane >> 4;
    const bf16* xbcc = (const bf16*)(a.ws + WS_XBCC); const bf16* proj = (const bf16*)(a.ws + WS_PROJ); const float* dtr = (const float*)(a.ws + WS_DT);
    bf16* Y = (bf16*)(a.ws + WS_Y); float* ssq = (float*)(a.ws + WS_SSQ);
    LAS float* sm = (LAS float*)(lds + O_SM);
    for (int item = blockIdx.x; item < 256; item += G) {
        const int xcd = item & 7, jj = item >> 3, pair = xcd * 4 + (jj >> 3), b = pair >> 3, g = pair & 7, h = g * 8 + (jj & 7);
        const float A_h = -expf(a.in[13][h]), D_h = a.in[14][h], bias_h = a.in[12][h];
        f32x4 hacc[4];
#pragma unroll
        for (int i = 0; i < 4; ++i) hacc[i] = (f32x4){0.f, 0.f, 0.f, 0.f};
        u32x4 rx[2], rB[4], rC[4]; float rd0 = 0.f, rd1 = 0.f;
#define SSD_LOAD(cc) do { const size_t t0_ = (size_t)b * 2048 + (size_t)(cc) * 128; \
        _Pragma("unroll") for (int i = 0; i < 2; ++i) { const int id = tid + 512 * i, l = id >> 3, pc = id & 7; rx[i] = *(const u32x4*)(xbcc + (t0_ + l) * 6144 + h * 64 + pc * 8); } \
        _Pragma("unroll") for (int i = 0; i < 4; ++i) { const int id = tid + 512 * i, l = id >> 4, nc = id & 15; const bf16* p = xbcc + (t0_ + l) * 6144 + 4096 + g * 128 + nc * 8; rB[i] = *(const u32x4*)p; rC[i] = *(const u32x4*)(p + 1024); } \
        if (w == 0) { rd0 = dtr[(t0_ + 2 * lane) * 64 + h]; rd1 = dtr[(t0_ + 2 * lane + 1) * 64 + h]; } } while (0)
        SSD_LOAD(0);
        for (int c = 0; c < 16; ++c) {
            const size_t t0 = (size_t)b * 2048 + (size_t)c * 128;
            __syncthreads();
            if (w == 0) {
                const float d0 = softplusf_(rd0 + bias_h), d1 = softplusf_(rd1 + bias_h), a0 = d0 * A_h, a1 = d1 * A_h;
                float s = a0 + a1;
#pragma unroll
                for (int off = 1; off < 64; off <<= 1) { const float t = __shfl_up(s, off); if (lane >= off) s += t; }
                const float ac1 = s, ac0 = s - a1, tot = __shfl(s, 63);
                sm[2 * lane] = ac0; sm[2 * lane + 1] = ac1; sm[128 + 2 * lane] = d0; sm[129 + 2 * lane] = d1;
                sm[256 + 2 * lane] = __expf(tot - ac0) * d0; sm[257 + 2 * lane] = __expf(tot - ac1) * d1;
                sm[384 + 2 * lane] = __expf(ac0); sm[385 + 2 * lane] = __expf(ac1);
                if (lane == 0) sm[512] = __expf(tot);
            }
#pragma unroll
            for (int i = 0; i < 4; ++i) { const int p = (w & 3) * 16 + fr, n = ((w >> 2) * 4 + i) * 16 + 4 * q;
                *(LAS u32x2*)(lds + O_HS + sw128(p, n)) = (u32x2){pk2(hacc[i].x, hacc[i].y), pk2(hacc[i].z, hacc[i].w)}; }
#pragma unroll
            for (int i = 0; i < 4; ++i) { const int id = tid + 512 * i, l = id >> 4, nc = id & 15;
                *(LAS u32x4*)(lds + O_BS + sw128(l, nc * 8)) = rB[i]; *(LAS u32x4*)(lds + O_CS + sw128(l, nc * 8)) = rC[i];
#pragma unroll
                for (int j = 0; j < 8; ++j) *(LAS bf16*)(lds + O_BT + (nc * 8 + j) * 272 + l * 2) = (bf16)bfx(rB[i], j); }
#pragma unroll
            for (int i = 0; i < 2; ++i) { const int id = tid + 512 * i, l = id >> 3, pc = id & 7;
#pragma unroll
                for (int j = 0; j < 8; ++j) *(LAS bf16*)(lds + O_XT + (pc * 8 + j) * 272 + l * 2) = (bf16)bfx(rx[i], j); }
            __syncthreads();
#pragma unroll
            for (int i = 0; i < 2; ++i) { const int id = tid + 512 * i, l = id >> 3, pc = id & 7; const float wl = sm[256 + l];
#pragma unroll
                for (int j = 0; j < 8; ++j) *(LAS bf16*)(lds + O_XW + (pc * 8 + j) * 272 + l * 2) = (bf16)f2bf(bf1(bfx(rx[i], j)) * wl); }
            if (c + 1 < 16) SSD_LOAD(c + 1);
            f32x4 cb[8];
            { bf16x8 cf[4];
#pragma unroll
              for (int ks = 0; ks < 4; ++ks) cf[ks] = ldfrag(lds + O_CS, 16 * w + fr, ks, q);
#pragma unroll
              for (int st = 0; st < 8; ++st) { cb[st] = (f32x4){0.f, 0.f, 0.f, 0.f};
                  if (st <= w) {
#pragma unroll
                      for (int ks = 0; ks < 4; ++ks) cb[st] = MFMA16(ldfrag(lds + O_BS, 16 * st + fr, ks, q), cf[ks], cb[st]); } } }
            __syncthreads();
            { const int l = 16 * w + fr; const float al = sm[l];
#pragma unroll
              for (int st = 0; st < 8; ++st) { const int s0 = 16 * st + 4 * q; const f32x4 as = *(LAS const f32x4*)(sm + s0), ds = *(LAS const f32x4*)(sm + 128 + s0); float v[4];
#pragma unroll
                  for (int r = 0; r < 4; ++r) v[r] = (s0 + r <= l) ? cb[st][r] * __expf(al - as[r]) * ds[r] : 0.f;
                  *(LAS u32x2*)(lds + O_BS + sw128(l, s0)) = (u32x2){pk2(v[0], v[1]), pk2(v[2], v[3])}; } }
            __syncthreads();
            const size_t row = t0 + 16 * w + fr;
            { const float dec = sm[512];
#pragma unroll
              for (int i = 0; i < 4; ++i) { hacc[i] = hacc[i] * dec; const int nt = (w >> 2) * 4 + i;
#pragma unroll
                  for (int ks = 0; ks < 4; ++ks) hacc[i] = MFMA16(ldfragp(lds + O_BT, 16 * nt + fr, ks, q), ldfragp(lds + O_XW, 16 * (w & 3) + fr, ks, q), hacc[i]); } }
            { const int l = 16 * w + fr; const float el = sm[384 + l]; float ss = 0.f;
              bf16x8 wf[4], cf2[4];
#pragma unroll
              for (int ks = 0; ks < 4; ++ks) { wf[ks] = ldfrag(lds + O_BS, 16 * w + fr, ks, q); cf2[ks] = ldfrag(lds + O_CS, 16 * w + fr, ks, q); }
#pragma unroll
              for (int ph = 0; ph < 2; ++ph) {
                  u32x2 zq[2]; f32x4 yd[2], yo[2];
#pragma unroll
                  for (int pp = 0; pp < 2; ++pp) { const int pt = 2 * ph + pp; zq[pp] = *(const u32x2*)(proj + row * NPROJ + C_Z + h * 64 + 16 * pt + 4 * q);
                      yd[pp] = (f32x4){0.f, 0.f, 0.f, 0.f}; yo[pp] = (f32x4){0.f, 0.f, 0.f, 0.f};
#pragma unroll
                      for (int ks = 0; ks < 4; ++ks) {
                          if (ks <= (w >> 1)) yd[pp] = MFMA16(ldfragp(lds + O_XT, 16 * pt + fr, ks, q), wf[ks], yd[pp]);
                          yo[pp] = MFMA16(ldfrag(lds + O_HS, 16 * pt + fr, ks, q), cf2[ks], yo[pp]); } }
#pragma unroll
                  for (int pp = 0; pp < 2; ++pp) { const int pt = 2 * ph + pp, p0 = 16 * pt + 4 * q; const float zf[4] = {bflo(zq[pp].x), bfhi(zq[pp].x), bflo(zq[pp].y), bfhi(zq[pp].y)}; float yv[4];
#pragma unroll
                      for (int r = 0; r < 4; ++r) { const float xv = bf1(*(LAS const bf16*)(lds + O_XT + (p0 + r) * 272 + l * 2)); float y = yd[pp][r] + el * yo[pp][r] + D_h * xv; y *= siluf_(zf[r]); ss += y * y; yv[r] = y; }
                      *(u32x2*)(Y + row * 4096 + h * 64 + p0) = (u32x2){pk2(yv[0], yv[1]), pk2(yv[2], yv[3])}; }
                  __builtin_amdgcn_sched_barrier(0);
              }
              ss += __shfl_xor(ss, 16); ss += __shfl_xor(ss, 32);
              if (q == 0) ssq[row * 64 + h] = ss; }
        }
#undef SSD_LOAD
#pragma unroll
        for (int i = 0; i < 4; ++i) { const int p = (w & 3) * 16 + fr, n = ((w >> 2) * 4 + i) * 16 + 4 * q;
            *(f32x4*)(a.out + O_SSMP + (((size_t)(b * 64 + h) * 64 + p) * 128 + n)) = hacc[i]; }
    }
}

__device__ __forceinline__ void ssd_sample(const Args& a, LAS unsigned char* lds, int G) {
    constexpr int O_XT2 = 0, O_XW2 = 1024, O_BT2 = 2048;
    const int tid = threadIdx.x, lane = tid & 63, w = __builtin_amdgcn_readfirstlane(tid >> 6), fr = lane & 15, q = lane >> 4, l7 = lane & 7;
    LAS unsigned char* L = lds + w * 8192;
    const bf16* xbcc = (const bf16*)(a.ws + WS_XBCC); const bf16* proj = (const bf16*)(a.ws + WS_PROJ); const float* dtr = (const float*)(a.ws + WS_DT);
    bf16* Y = (bf16*)(a.ws + WS_Y); float* ssq = (float*)(a.ws + WS_SSQ);
    const bf16x8 zero8 = {0, 0, 0, 0, 0, 0, 0, 0};
    for (int pair = blockIdx.x; pair < 1024; pair += G) {
        const int sb = pair >> 3, g = pair & 7, h = g * 8 + w;
        const size_t r0 = (size_t)NPR + (size_t)sb * 8;
        const float A_h = -expf(a.in[13][h]), D_h = a.in[14][h], bias_h = a.in[12][h];
        const float d = softplusf_(dtr[(r0 + l7) * 64 + h] + bias_h);
        float s = d * A_h;
#pragma unroll
        for (int off = 1; off < 8; off <<= 1) { const float t = __shfl_up(s, off, 8); if (l7 >= off) s += t; }
        const float tot = __shfl(s, 7, 8), wend = __expf(tot - s) * d, eA = __expf(s), dec = __expf(tot);
        LDS_WAIT();
        { const int l = lane >> 3, pc = lane & 7; const u32x4 rx = *(const u32x4*)(xbcc + (r0 + l) * 6144 + h * 64 + pc * 8); const float wl = __shfl(wend, l);
#pragma unroll
          for (int j = 0; j < 8; ++j) { const u32 e = bfx(rx, j); *(LAS bf16*)(L + O_XT2 + (pc * 8 + j) * 16 + l * 2) = (bf16)e; *(LAS bf16*)(L + O_XW2 + (pc * 8 + j) * 16 + l * 2) = (bf16)f2bf(bf1(e) * wl); } }
#pragma unroll
        for (int i = 0; i < 2; ++i) { const int id = lane + 64 * i, l = id >> 4, nc = id & 15; const u32x4 rb = *(const u32x4*)(xbcc + (r0 + l) * 6144 + 4096 + g * 128 + nc * 8);
#pragma unroll
            for (int j = 0; j < 8; ++j) *(LAS bf16*)(L + O_BT2 + (nc * 8 + j) * 16 + l * 2) = (bf16)bfx(rb, j); }
        bf16x8 bfr[4], cf[4];
#pragma unroll
        for (int ks = 0; ks < 4; ++ks) {
            if (fr < 8) { const bf16* p = xbcc + (r0 + fr) * 6144 + 4096 + g * 128 + 32 * ks + 8 * q; bfr[ks] = *(const bf16x8*)p; cf[ks] = *(const bf16x8*)(p + 1024); }
            else { bfr[ks] = zero8; cf[ks] = zero8; } }
        f32x4 cb = {0.f, 0.f, 0.f, 0.f};
#pragma unroll
        for (int ks = 0; ks < 4; ++ks) cb = MFMA16(bfr[ks], cf[ks], cb);
        const float al = __shfl(s, fr & 7);
        float wv[4], wh[4];
#pragma unroll
        for (int r = 0; r < 4; ++r) { const int sI = 4 * q + r; const float as = __shfl(s, sI & 7), ds = __shfl(d, sI & 7); wv[r] = (fr < 8 && sI < 8 && sI <= fr) ? cb[r] * __expf(al - as) * ds : 0.f; }
#pragma unroll
        for (int r = 0; r < 4; ++r) wh[r] = __shfl(wv[r], (lane + 16) & 63);
        bf16x8 wf = zero8;
        if (q == 0) { u32x4 t; t.x = pk2(wv[0], wv[1]); t.y = pk2(wv[2], wv[3]); t.z = pk2(wh[0], wh[1]); t.w = pk2(wh[2], wh[3]); wf = __builtin_bit_cast(bf16x8, t); }
        const float el = __shfl(eA, fr & 7);
        LDS_WAIT();
        float ss = 0.f;
        const size_t hoff = ((size_t)(sb * 64 + h) * 64) * 128;
        const float* hin = a.in[2] + hoff; float* hout = a.out + O_SSMS + hoff;
        for (int pt = 0; pt < 4; ++pt) {
            f32x4 H[4][2]; const float* hp = hin + (size_t)(16 * pt + fr) * 128 + 8 * q;
#pragma unroll
            for (int ks = 0; ks < 4; ++ks) { H[ks][0] = *(const f32x4*)(hp + 32 * ks); H[ks][1] = *(const f32x4*)(hp + 32 * ks + 4); }
            u32x2 zq = {0u, 0u};
            if (fr < 8) zq = *(const u32x2*)(proj + (r0 + fr) * NPROJ + C_Z + h * 64 + 16 * pt + 4 * q);
            f32x4 yo = {0.f, 0.f, 0.f, 0.f};
#pragma unroll
            for (int ks = 0; ks < 4; ++ks) { u32x4 t; t.x = pk2(H[ks][0].x, H[ks][0].y); t.y = pk2(H[ks][0].z, H[ks][0].w); t.z = pk2(H[ks][1].x, H[ks][1].y); t.w = pk2(H[ks][1].z, H[ks][1].w);
                yo = MFMA16(__builtin_bit_cast(bf16x8, t), cf[ks], yo); }
            yo = yo * el;
            bf16x8 xf = zero8, xwf = zero8;
            if (q == 0) { xf = *(LAS const bf16x8*)(L + O_XT2 + (16 * pt + fr) * 16); xwf = *(LAS const bf16x8*)(L + O_XW2 + (16 * pt + fr) * 16); }
            yo = MFMA16(xf, wf, yo);
            { const int p0 = 16 * pt + 4 * q; const float zf[4] = {bflo(zq.x), bfhi(zq.x), bflo(zq.y), bfhi(zq.y)}; float yv[4];
#pragma unroll
              for (int r = 0; r < 4; ++r) { const float xv = bf1(*(LAS const bf16*)(L + O_XT2 + (p0 + r) * 16 + (fr & 7) * 2)); float y = yo[r] + D_h * xv; y *= siluf_(zf[r]); yv[r] = y; ss += (fr < 8) ? y * y : 0.f; }
              if (fr < 8) *(u32x2*)(Y + (r0 + fr) * 4096 + h * 64 + p0) = (u32x2){pk2(yv[0], yv[1]), pk2(yv[2], yv[3])}; }
#pragma unroll
            for (int ks = 0; ks < 4; ++ks)
#pragma unroll
                for (int hf = 0; hf < 2; ++hf) { const int n = 32 * ks + 8 * (fr >> 2) + (fr & 3) + 4 * hf;
                    bf16x8 btf = zero8; if (q == 0) btf = *(LAS const bf16x8*)(L + O_BT2 + n * 16);
                    f32x4 acc = H[ks][hf] * dec; acc = MFMA16(btf, xwf, acc);
                    *(f32x4*)(hout + (size_t)(16 * pt + fr) * 128 + 32 * ks + 8 * q + 4 * hf) = acc; }
        }
        ss += __shfl_xor(ss, 16); ss += __shfl_xor(ss, 32);
        if (q == 0 && fr < 8) ssq[(r0 + fr) * 64 + h] = ss;
    }
}

__device__ __forceinline__ void ph_ynorm(const Args& a, int G) {
    const int gt = blockIdx.x * 512 + threadIdx.x, NT = G * 512;
    bf16* Y = (bf16*)(a.ws + WS_Y); const float* ssq = (const float*)(a.ws + WS_SSQ);
    for (int idx = gt; idx < NROW * 512; idx += NT) { const int row = idx >> 9, ch = idx & 511, gi = ch >> 6;
        const f32x4 s0 = *(const f32x4*)(ssq + (size_t)row * 64 + 8 * gi), s1 = *(const f32x4*)(ssq + (size_t)row * 64 + 8 * gi + 4);
        const float rs = rsqrtf(((s0.x + s0.y) + (s0.z + s0.w) + (s1.x + s1.y) + (s1.z + s1.w)) * (1.f / 512.f) + EPS);
        u32x4* p = (u32x4*)(Y + (size_t)row * 4096 + 8 * ch); float t[8]; unpack8(*p, t);
#pragma unroll
        for (int e = 0; e < 8; ++e) t[e] *= rs;
        *p = pack8(t); }
}

__device__ __forceinline__ void ph_hconv(const Args& a, int G) {
    const int gt = blockIdx.x * 512 + threadIdx.x, NT = G * 512;
    const bf16* gup = (const bf16*)(a.ws + WS_PROJ); bf16* H = (bf16*)(a.ws + WS_H); float* out = a.out;
    for (int u = gt; u < 1152 * 704; u += NT) {
        const int tg = u / 704, c0 = (u - tg * 704) * 8, r0 = tg * 8; const bool prompt = tg < 1024; const int sb = tg - 1024, pb = tg >> 8;
        float wk[3][8], bs[8], gp[2][8];
#pragma unroll
        for (int k = 0; k < 3; ++k) ld8f(a.in[23] + k * 5632 + c0, wk[k]);
        ld8f(a.in[24] + c0, bs);
#pragma unroll
        for (int k = 0; k < 2; ++k) {
            if (prompt) { if ((tg & 255) == 0) {
#pragma unroll
                    for (int e = 0; e < 8; ++e) gp[k][e] = 0.f; }
                else unpack8(*(const u32x4*)(gup + (size_t)(r0 - 2 + k) * 11264 + c0), gp[k]); }
            else ld8f(a.in[5] + ((size_t)sb * 2 + k) * 5632 + c0, gp[k]); }
        const bool last = prompt ? ((tg & 255) == 255) : true;
#pragma unroll
        for (int j = 0; j < 8; ++j) {
            float gc[8], uv[8], o[8]; const bf16* p = gup + (size_t)(r0 + j) * 11264 + c0; unpack8(*(const u32x4*)p, gc); unpack8(*(const u32x4*)(p + 5632), uv);
#pragma unroll
            for (int e = 0; e < 8; ++e) { const float y = bs[e] + wk[0][e] * gp[0][e] + wk[1][e] * gp[1][e] + wk[2][e] * gc[e]; o[e] = siluf_(y) * uv[e]; }
            *(u32x4*)(H + (size_t)(r0 + j) * 5632 + c0) = pack8(o);
            if (j >= 6 && last) { float* d = prompt ? out + O_FFP + ((size_t)pb * 2 + (j - 6)) * 5632 + c0 : out + O_FFS + ((size_t)sb * 2 + (j - 6)) * 5632 + c0; st8f(d, gc); }
#pragma unroll
            for (int e = 0; e < 8; ++e) { gp[0][e] = gp[1][e]; gp[1][e] = gc[e]; } }
    }
}

__device__ __forceinline__ void ph_final(const Args& a, int G) {
    const int tid = threadIdx.x, lane = tid & 63, w = tid >> 6, gw = blockIdx.x * 8 + w, NGW = G * 8;
    const f32x4* gn = (const f32x4*)a.in[29] + lane;
    for (int m = gw; m < NROW; m += NGW) {
        f32x4* xr = (f32x4*)(a.out + O_Y + (size_t)m * DM) + lane; f32x4 v[8]; float s = 0.f;
#pragma unroll
        for (int j = 0; j < 8; ++j) { v[j] = xr[64 * j]; s += (v[j].x * v[j].x + v[j].y * v[j].y) + (v[j].z * v[j].z + v[j].w * v[j].w); }
        const float rs = rsqrtf(wave_sum(s) * (1.f / DM) + EPS);
#pragma unroll
        for (int j = 0; j < 8; ++j) xr[64 * j] = v[j] * rs * gn[64 * j]; }
}

__global__ void __launch_bounds__(512, 2) mk_fwd(Args a) {
    extern __shared__ __attribute__((aligned(16))) unsigned char lds_raw[];
    LAS unsigned char* lds = (LAS unsigned char*)lds_raw;
    cg::grid_group grid = cg::this_grid();
    const int G = gridDim.x, lo = a.ph_lo, hi = a.ph_hi;
    unsigned char* ws = a.ws;
    typedef pg8::StaticOrder SO;
#ifdef MK_ONLY
#define IN(k) ((k) == MK_ONLY && lo <= (k) && (k) < hi)
#else
#define IN(k) (lo <= (k) && (k) < hi)
#endif
#define SEAM(k) do { if (IN(k) && IN((k) + 1)) grid.sync(); } while (0)
    if (IN(0)) ph_prologue(a, lds, G);
    SEAM(0);
    if (IN(1)) { pg8::Gemm g{(const bf16*)(ws + WS_XB), (const bf16*)(ws + WS_WIN), NROW, NPROJ, 2048}; SO S; S.init(NROW, NPROJ, G, (int)blockIdx.x);
        EpiProj E{(bf16*)(ws + WS_PROJ), (float*)(ws + WS_DT), (const float*)(ws + WS_RS)};
        pg8::gemm_phase<EpiProj, SO, true, true>(lds, g, S, E); }
    SEAM(1);
    if (IN(2)) ph_conv(a, G);
    SEAM(2);
    if (IN(3)) {
#ifndef NO_PROMPT
        ssd_prompt(a, lds, G);
#endif
        __syncthreads();
#ifndef NO_SAMPLE
        ssd_sample(a, lds, G);
#endif
    }
    SEAM(3);
    if (IN(4)) ph_ynorm(a, G);
    SEAM(4);
    if (IN(5)) {
        { pg8::Gemm g{(const bf16*)(ws + WS_Y), (const bf16*)(ws + WS_WA), NROW, DM, 4096}; SO S; S.init(NROW, DM, G, (int)blockIdx.x);
          EpiGateA E{(const bf16*)(ws + WS_PROJ), (float*)(ws + WS_XBCC)}; pg8::gemm_phase<EpiGateA, SO, true, true>(lds, g, S, E); }
        { pg8::Gemm g{(const bf16*)(ws + WS_SCBC), (const bf16*)(ws + WS_WB), NROW, DM, 2048}; SO S; S.init(NROW, DM, G, (int)blockIdx.x);
          EpiGateB E{(const bf16*)(ws + WS_PROJ), (const float*)(ws + WS_XBCC), (bf16*)(ws + WS_MIX)}; pg8::gemm_phase<EpiGateB, SO, true, true>(lds, g, S, E); } }
    SEAM(5);
    if (IN(6)) { pg8::Gemm g{(const bf16*)(ws + WS_MIX), (const bf16*)(ws + WS_WO), NROW, DM, 2048}; SO S; S.init(NROW, DM, G, (int)blockIdx.x);
        EpiRes E{a.in[0], a.in[1] - (size_t)NPR * DM, a.out + O_Y, (bf16*)(ws + WS_XB), (float*)(ws + WS_RS) + NROW}; pg8::gemm_phase<EpiRes, SO, true, true>(lds, g, S, E); }
    SEAM(6);
    if (IN(7)) { pg8::Gemm g{(const bf16*)(ws + WS_XB), (const bf16*)(ws + WS_WGU), NROW, 11264, 2048}; SO S; S.init(NROW, 11264, G, (int)blockIdx.x);
        EpiGU E{(const float*)(ws + WS_RS) + NROW, (bf16*)(ws + WS_PROJ)}; pg8::gemm_phase<EpiGU, SO, true, true>(lds, g, S, E); }
    SEAM(7);
    if (IN(8)) ph_hconv(a, G);
    SEAM(8);
    if (IN(9)) { pg8::Gemm g{(const bf16*)(ws + WS_H), (const bf16*)(ws + WS_WDN), NROW, DM, 5632}; SO S; S.init(NROW, DM, G, (int)blockIdx.x);
        EpiRes E{a.out + O_Y, a.out + O_Y, a.out + O_Y, (bf16*)(ws + WS_MIX), (float*)(ws + WS_RS) + 2 * NROW}; pg8::gemm_phase<EpiRes, SO, true, true>(lds, g, S, E); }
    SEAM(9);
    if (IN(10)) {
#ifndef NO_P10A
        { int kple = 256; asm volatile("" : "+s"(kple));
          pg8::Gemm g{(const bf16*)(ws + WS_PEB), (const bf16*)(ws + WS_WPLE), NROW, DM, kple}; SO S; S.init(NROW, DM, G, (int)blockIdx.x);
          EpiF32 E{(float*)(ws + WS_XBCC)}; pg8::gemm_phase<EpiF32, SO, true, true>(lds, g, S, E); }
#endif
#ifndef NO_P10B
        { pg8::Gemm g{(const bf16*)(ws + WS_MIX), (const bf16*)(ws + WS_WPG), NROW, DM, 2048}; SO S; S.init(NROW, DM, G, (int)blockIdx.x);
          EpiPle E{(const float*)(ws + WS_RS) + 2 * NROW, (const float*)(ws + WS_XBCC), a.out + O_Y}; pg8::gemm_phase<EpiPle, SO, true, true>(lds, g, S, E); }
#endif
    }
    SEAM(10);
    if (IN(11)) ph_final(a, G);
#undef IN
#undef SEAM
}

extern "C" void kernel_launch(void* const* d_in, const int* in_sizes, int n_in, void* d_out, int out_size, void* d_ws, size_t ws_size, hipStream_t stream) {
    static int grid = 0;
    if (grid == 0) {
        if (n_in != 30 || (size_t)out_size != O_END || ws_size < WS_END) { fprintf(stderr, "kernel_launch: unexpected sizes n_in %d out %d ws %zu\n", n_in, out_size, ws_size); grid = -1; return; }
        int dev = 0, cus = 0, per_cu = 0;
        if (hipGetDevice(&dev) != hipSuccess || hipDeviceGetAttribute(&cus, hipDeviceAttributeMultiprocessorCount, dev) != hipSuccess) { grid = -1; return; }
        if (hipFuncSetAttribute((const void*)mk_fwd, hipFuncAttributeMaxDynamicSharedMemorySize, LDS_BYTES) != hipSuccess) { fprintf(stderr, "kernel_launch: hipFuncSetAttribute failed\n"); grid = -1; return; }
        if (hipOccupancyMaxActiveBlocksPerMultiprocessor(&per_cu, (const void*)mk_fwd, 512, LDS_BYTES) != hipSuccess || per_cu < 1) { fprintf(stderr, "kernel_launch: occupancy query says %d\n", per_cu); (void)hipGetLastError(); grid = -1; return; }
        grid = cus * 1;
    }
    if (grid < 0) return;
    Args a{};
    for (int i = 0; i < 30; ++i) a.in[i] = (const float*)d_in[i];
    a.out = (float*)d_out; a.ws = (unsigned char*)d_ws;
#if MK_ONE_LAUNCH
    a.ph_lo = 0; a.ph_hi = MK_MAXPH;
    void* args[] = {&a};
    hipError_t e = hipLaunchCooperativeKernel((const void*)mk_fwd, dim3(grid), dim3(512), args, LDS_BYTES, stream);
    if (e != hipSuccess) fprintf(stderr, "kernel_launch: cooperative launch failed: %s (grid %d)\n", hipGetErrorString(e), grid);
#else
    for (int p = 0; p < MK_MAXPH; ++p) { a.ph_lo = p; a.ph_hi = p + 1; hipLaunchKernelGGL(mk_fwd, dim3(grid), dim3(512), LDS_BYTES, stream, a); }
#endif
}
```
